# Optimizing an MI355X kernel written in HIP

```python
import jax, jax.numpy as jnp
from jax import lax
import numpy as np

D_MODEL = 1024
BATCH = 8
SEQ = 2048
DEPTH = 1
DEC_BATCH = 4
DEC_SEQ = 8192
PAST_LEN = 128

D_MIX = D_MODEL
D_A = D_MIX // 2
N_HEADS_A = 4
HEAD_A = D_A // N_HEADS_A
CHUNK_A = 128
D_B = D_MIX - D_A
N_HEADS_B = 4
HEAD_V_B = D_B // N_HEADS_B
D_K_B = D_B // 2
HEAD_K_B = D_K_B // N_HEADS_B
GATE_RANK = 16
GATE_NORMALIZER = 16.0
CHUNK_B = 64
EPS = 1e-6
SPLITS = [D_A, D_A, D_A, D_K_B, D_K_B, D_B, D_B, GATE_RANK, GATE_RANK]
D_IN = sum(SPLITS)

kernel_name = "hybrid_gmlp_gla_bidir_encoder"


def rmsnorm(x, g):
    xf = x.astype(jnp.float32)
    xf = xf * lax.rsqrt(jnp.mean(xf * xf, axis=-1, keepdims=True) + EPS)
    return (xf * g.astype(jnp.float32)).astype(x.dtype)


def layernorm(x, g):
    xf = x.astype(jnp.float32)
    xf = xf - jnp.mean(xf, axis=-1, keepdims=True)
    xf = xf * lax.rsqrt(jnp.mean(xf * xf, axis=-1, keepdims=True) + EPS)
    return (xf * g.astype(jnp.float32)).astype(x.dtype)


def spatial_gating(u, v, w_sp, b_sp, g_v):
    bsz, s, _ = u.shape
    v = layernorm(v, g_v)
    vc = v.reshape(bsz, s // CHUNK_A, CHUNK_A, N_HEADS_A, HEAD_A)
    sv = jnp.einsum('hij,bcjhd->bcihd', w_sp, vc) + b_sp.T[None, None, :, :, None]
    return u * sv.reshape(bsz, s, D_A).astype(u.dtype)


def gla_direction(q, k, v, g, strict):
    bsz, s, h, dk = q.shape
    dv = v.shape[-1]
    n = s // CHUNK_B
    f32 = jnp.float32
    q = q.astype(f32).reshape(bsz, n, CHUNK_B, h, dk)
    k = k.astype(f32).reshape(bsz, n, CHUNK_B, h, dk)
    v = v.astype(f32).reshape(bsz, n, CHUNK_B, h, dv)
    g = g.astype(f32).reshape(bsz, n, CHUNK_B, h, dk)
    bcum = jnp.cumsum(g, axis=2)
    b_last = bcum[:, :, -1:]
    q_in = q * jnp.exp(bcum)
    k_in = k * jnp.exp(-bcum)
    scores = jnp.einsum('bnchd,bnjhd->bnhcj', q_in, k_in)
    idx = jnp.arange(CHUNK_B)
    mask = (idx[:, None] > idx[None, :]) if strict else (idx[:, None] >= idx[None, :])
    scores = jnp.where(mask, scores, 0.0)
    o_intra = jnp.einsum('bnhcj,bnjhe->bnche', scores, v)
    k_dec = k * jnp.exp(b_last - bcum)
    chunk_kv = jnp.einsum('bnjhd,bnjhe->bnhde', k_dec, v)
    decay = jnp.exp(b_last[:, :, 0])

    def step(state, inp):
        kv_c, dec_c = inp
        return dec_c[..., None] * state + kv_c, state

    init = jnp.zeros((bsz, h, dk, dv), f32)
    _, states = lax.scan(step, init, (jnp.moveaxis(chunk_kv, 1, 0), jnp.moveaxis(decay, 1, 0)))
    states = jnp.moveaxis(states, 0, 1)
    o_inter = jnp.einsum('bnchd,bnhde->bnche', q_in, states)
    return (o_intra + o_inter).reshape(bsz, s, h, dv)


def hybrid_layer(x, norm_pre, w_in, w_sp, b_sp, g_v_a, w_gk_fwd, b_gk_fwd,
                 w_gk_bwd, b_gk_bwd, g_norm_b, w_out, norm_post):
    bsz, s, _ = x.shape
    h = rmsnorm(x, norm_pre)
    p = h @ w_in
    offs = np.cumsum(SPLITS)[:-1].tolist()
    u_a, v_a, z_a, q_b, k_b, v_b, z_b, lr_f, lr_b = jnp.split(p, offs, axis=-1)

    out_a = spatial_gating(jax.nn.gelu(u_a), jax.nn.gelu(v_a), w_sp, b_sp, g_v_a)
    out_a = out_a * jax.nn.silu(z_a)

    q = q_b.reshape(bsz, s, N_HEADS_B, HEAD_K_B) * (HEAD_K_B ** -0.5)
    k = k_b.reshape(bsz, s, N_HEADS_B, HEAD_K_B)
    v = v_b.reshape(bsz, s, N_HEADS_B, HEAD_V_B)
    g_f = jax.nn.log_sigmoid((lr_f @ w_gk_fwd + b_gk_fwd).astype(jnp.float32)) / GATE_NORMALIZER
    g_b = jax.nn.log_sigmoid((lr_b @ w_gk_bwd + b_gk_bwd).astype(jnp.float32)) / GATE_NORMALIZER
    g_f = g_f.reshape(bsz, s, N_HEADS_B, HEAD_K_B)
    g_b = g_b.reshape(bsz, s, N_HEADS_B, HEAD_K_B)
    o_fwd = gla_direction(q, k, v, g_f, strict=False)
    flip = lambda t: jnp.flip(t, axis=1)
    o_bwd = flip(gla_direction(flip(q), flip(k), flip(v), flip(g_b), strict=True))
    o_b = rmsnorm((o_fwd + o_bwd).astype(x.dtype), g_norm_b)
    out_b = o_b.reshape(bsz, s, D_B) * jax.nn.silu(z_b)

    mixed = jnp.concatenate([out_a, out_b], axis=-1) @ w_out
    return x + rmsnorm(mixed, norm_post)


def setup_inputs(seed: int = 0) -> dict:
    key = jax.random.key(seed)
    ks = jax.random.split(key, 16)
    f32 = jnp.float32
    nrm = lambda k, shape, scale: jax.random.normal(k, shape, f32) * scale
    return {
        "x_prompt": nrm(ks[0], (BATCH, SEQ, D_MODEL), 1.0),
        "x_sample": nrm(ks[1], (DEC_BATCH, DEC_SEQ, D_MODEL), 1.0),
        "norm_pre": 1.0 + nrm(ks[2], (DEPTH, D_MODEL), 0.02),
        "w_in": nrm(ks[3], (DEPTH, D_MODEL, D_IN), D_MODEL ** -0.5),
        "w_sp": nrm(ks[4], (DEPTH, N_HEADS_A, CHUNK_A, CHUNK_A), 0.5 * CHUNK_A ** -0.5),
        "b_sp": 1.0 + nrm(ks[5], (DEPTH, N_HEADS_A, CHUNK_A), 0.02),
        "g_v_a": 1.0 + nrm(ks[6], (DEPTH, D_A), 0.02),
        "w_gk_fwd": nrm(ks[7], (DEPTH, GATE_RANK, D_K_B), GATE_RANK ** -0.5),
        "b_gk_fwd": nrm(ks[8], (DEPTH, D_K_B), 0.01),
        "w_gk_bwd": nrm(ks[9], (DEPTH, GATE_RANK, D_K_B), GATE_RANK ** -0.5),
        "b_gk_bwd": nrm(ks[10], (DEPTH, D_K_B), 0.01),
        "g_norm_b": 1.0 + nrm(ks[11], (DEPTH, HEAD_V_B), 0.02),
        "w_out": nrm(ks[12], (DEPTH, D_MIX, D_MODEL), D_MIX ** -0.5),
        "norm_post": 1.0 + nrm(ks[13], (DEPTH, D_MODEL), 0.02),
    }


def reference(x_prompt, x_sample, norm_pre, w_in, w_sp, b_sp, g_v_a, w_gk_fwd, b_gk_fwd,
              w_gk_bwd, b_gk_bwd, g_norm_b, w_out, norm_post):
    y_prompt = x_prompt
    y_sample = x_sample
    for l in range(DEPTH):
        params = (norm_pre[l], w_in[l], w_sp[l], b_sp[l], g_v_a[l], w_gk_fwd[l], b_gk_fwd[l],
                  w_gk_bwd[l], b_gk_bwd[l], g_norm_b[l], w_out[l], norm_post[l])
        y_prompt = hybrid_layer(y_prompt, *params)
        y_sample = hybrid_layer(y_sample, *params)
    return (y_prompt, y_sample)
```

```cpp
#include <hip/hip_runtime.h>
#include <cstdio>
#include <cstdint>
namespace pg8 {
#define PG8_LAS __attribute__((address_space(3)))
typedef unsigned short bf16_t;
typedef short bf16x8 __attribute__((ext_vector_type(8)));
typedef float f32x4 __attribute__((ext_vector_type(4)));
typedef unsigned u32x4 __attribute__((ext_vector_type(4)));
constexpr int BM = 256, BK = 64, HALF = 128, HTB = HALF * BK * 2  , STAGE_BYTES = 8 * HTB, NXCD = 8, WGM = 8;

__host__ __device__ __forceinline__ int lds_byte(int r, int c) { const int st = (r >> 4) * 2 + (c >> 5), rr = r & 15, cc = c & 31, ob = rr * 64 + cc * 2; return st * 1024 + (ob ^ (((ob >> 9) & 1) << 5)); }
__host__ __device__ __forceinline__ void stage_rc(int b, int& R, int& C) { const int st = b / 1024, sb = b % 1024, swz = sb ^ (((sb >> 9) & 1) << 5); R = (st >> 1) * 16 + swz / 64; C = (st & 1) * 32 + (swz % 64) / 2; }
__host__ __device__ __forceinline__ int perm32(int rho) { const int n = rho >> 4, i = rho & 15; return 8 * (i >> 2) + 4 * n + (i & 3); }

struct Unit { int pm, pn; };
struct Gemm { const bf16_t* A; const bf16_t* Bt; int M, N, K; };

struct StaticOrder {
    int nM, nN, nwg, G, c;
    __host__ __device__ void init(int M, int N, int G_, int c_) { nM = M / BM; nN = N / BM; nwg = nM * nN; G = G_; c = c_; }
    __host__ __device__ bool next(int i, Unit& u) const {
        const long L = (long)i * G + c; if (L >= nwg) return false;
        int wgid = (int)L; { const int q = nwg / NXCD, r = nwg % NXCD, xcd = wgid % NXCD, off = wgid / NXCD; wgid = (xcd < r ? xcd * (q + 1) : r * (q + 1) + (xcd - r) * q) + off; }
        const int nig = WGM * nN, gid = wgid / nig, fm = gid * WGM, gsz = (nM - fm) < WGM ? (nM - fm) : WGM;
        u.pm = fm + ((wgid % nig) % gsz); u.pn = (wgid % nig) / gsz; return true;
    }
    __device__ __forceinline__ void a_ready(const Unit&) const {}
    __device__ __forceinline__ void done(const Unit&) const {}
};

__device__ __forceinline__ unsigned cvt_pk_bf16(float lo, float hi) { unsigned r; asm volatile("v_cvt_pk_bf16_f32 %0, %1, %2" : "=v"(r) : "v"(lo), "v"(hi)); return r; }
__device__ __forceinline__ float gelu_tanh_f(float x) {
    const float u = x * (1.0f + 0.044715f * x * x);
    const float e = __builtin_amdgcn_exp2f(u * (-2.0f * 0.7978845608028654f * 1.4426950408889634f));
    return x * __builtin_amdgcn_rcpf(1.0f + e);
}
__device__ __forceinline__ float silu_f(float x) {
    const float e = __builtin_amdgcn_exp2f(x * -1.4426950408889634f);
    return x * __builtin_amdgcn_rcpf(1.0f + e);
}
template <int ACT> __device__ __forceinline__ float act_f(float x) {
    if (ACT == 1) return gelu_tanh_f(x);
    if (ACT == 2) return silu_f(x);
    if (ACT == 3) return x * 0.125f;
    return x;
}
struct EpiP1 {
    static constexpr bool PERM = true, AFTER_DRAIN = false;
    bf16_t* PA; bf16_t* PB; float* VSTAT;
    template <int ACT, bool STATS>
    __device__ __forceinline__ void body(const f32x4 (&acc)[2][2][4][2], bf16_t* base, int row0, int col0, int slot, int fq) const {
#pragma unroll
        for (int ai = 0; ai < 2; ++ai)
#pragma unroll
            for (int m = 0; m < 4; ++m) {
                const int row = row0 + ai * HALF + m * 16;
                bf16_t* rowp = base + (size_t)row * 1536 + col0;
                float s = 0.f, ss = 0.f;
#pragma unroll
                for (int bj = 0; bj < 2; ++bj) {
                    f32x4 v0 = acc[ai][bj][m][0], v1 = acc[ai][bj][m][1];
#pragma unroll
                    for (int e = 0; e < 4; ++e) { v0[e] = act_f<ACT>(v0[e]); v1[e] = act_f<ACT>(v1[e]); }
                    if (STATS) {
                        s += (v0[0] + v0[1]) + (v0[2] + v0[3]) + (v1[0] + v1[1]) + (v1[2] + v1[3]);
                        ss += (v0[0] * v0[0] + v0[1] * v0[1]) + (v0[2] * v0[2] + v0[3] * v0[3]) + (v1[0] * v1[0] + v1[1] * v1[1]) + (v1[2] * v1[2] + v1[3] * v1[3]);
                    }
                    u32x4 w; w.x = cvt_pk_bf16(v0[0], v0[1]); w.y = cvt_pk_bf16(v0[2], v0[3]); w.z = cvt_pk_bf16(v1[0], v1[1]); w.w = cvt_pk_bf16(v1[2], v1[3]);
                    *(u32x4*)(rowp + bj * HALF) = w;
                }
                if (STATS) {
                    s += __shfl_xor(s, 16); s += __shfl_xor(s, 32); ss += __shfl_xor(ss, 16); ss += __shfl_xor(ss, 32);
                    if (fq == 0) { float* p = VSTAT + ((size_t)row * 8 + slot) * 2; p[0] = s; p[1] = ss; }
                }
            }
    }
    __device__ __forceinline__ void operator()(const f32x4 (&acc)[2][2][4][2], const Unit& u, int wr, int wc, int fr, int fq) const {
        const int pn = u.pn;
        bf16_t* base = (pn < 6) ? PA + pn * 256 : PB + (pn - 6) * 256;
        const int row0 = u.pm * BM + wr * 64 + fr, col0 = wc * 32 + 8 * fq;
        if (pn < 2) body<1, false>(acc, base, row0, col0, 0, fq);
        else if (pn < 4) body<1, true>(acc, base, row0, col0, (pn - 2) * 4 + wc, fq);
        else if (pn < 6) body<2, false>(acc, base, row0, col0, 0, fq);
        else if (pn == 6) body<3, false>(acc, base, row0, col0, 0, fq);
        else if (pn < 10) body<0, false>(acc, base, row0, col0, 0, fq);
        else body<2, false>(acc, base, row0, col0, 0, fq);
    }
};
struct EpiMixed {
    static constexpr bool PERM = false, AFTER_DRAIN = false;
    float* C; float* SS;
    __device__ __forceinline__ void operator()(const f32x4 (&acc)[2][2][4][2], const Unit& u, int wr, int wc, int fr, int fq) const {
        const int row0 = u.pm * BM + wr * 64 + fr, col0 = u.pn * BM + wc * 32 + 4 * fq;
#pragma unroll
        for (int ai = 0; ai < 2; ++ai)
#pragma unroll
            for (int m = 0; m < 4; ++m) {
                const int row = row0 + ai * HALF + m * 16;
                float* rowp = C + (size_t)row * 1024 + col0; float ss = 0.f;
#pragma unroll
                for (int bj = 0; bj < 2; ++bj)
#pragma unroll
                    for (int n = 0; n < 2; ++n) { const f32x4 v = acc[ai][bj][m][n]; *(f32x4*)(rowp + bj * HALF + n * 16) = v; ss += (v[0] * v[0] + v[1] * v[1]) + (v[2] * v[2] + v[3] * v[3]); }
                ss += __shfl_xor(ss, 16); ss += __shfl_xor(ss, 32);
                if (fq == 0) SS[(size_t)row * 16 + u.pn * 4 + wc] = ss;
            }
    }
};
template <class Epi, class Sched, bool ALIGN_EPI = false, bool SP2 = false>
__device__ __forceinline__ void gemm_phase(PG8_LAS unsigned char* lds, const Gemm g, const Sched& S, const Epi& E) {
    const int tid = threadIdx.x, wid = __builtin_amdgcn_readfirstlane(tid >> 6), lane = tid & 63, wr = wid >> 2, wc = wid & 3, fr = lane & 15, fq = lane >> 4;
    const int K = g.K, nt = K / BK;
    unsigned voffA[2], voffB[2];
#pragma unroll
    for (int i = 0; i < 2; ++i) { int R, C; stage_rc(tid * 16 + i * 8192, R, C); const int Rb = Epi::PERM ? ((R & ~31) + perm32(R & 31)) : R;
        voffA[i] = (unsigned)(R * K + C) * 2u; voffB[i] = (unsigned)(Rb * K + C) * 2u; }
    const size_t kstep = (size_t)(BK * 2);
    const size_t hstep = (size_t)HALF * K * 2;
    const size_t tstep = 2 * hstep;
    const unsigned ldsw = (unsigned)wid * 1024u;
    const int aoff = lds_byte(wr * 64 + fr, fq * 8), boff = lds_byte(wc * 32 + fr, fq * 8);
#define PG8_SA(b, h) (((b) * 2 + (h)) * HTB)
#define PG8_SB(b, h) ((4 + (b) * 2 + (h)) * HTB)
#define PG8_STAGE(bufoff, gbase, voff) do { _Pragma("unroll") for (int _i = 0; _i < 2; ++_i) \
        __builtin_amdgcn_global_load_lds((const unsigned*)((const char*)(gbase) + (voff)[_i]), (PG8_LAS unsigned*)(lds + (bufoff) + ldsw + _i * 8192), 16, 0, 0); } while (0)
#define PG8_LDA(dst, b, h) do { _Pragma("unroll") for (int m = 0; m < 4; ++m) _Pragma("unroll") for (int k = 0; k < 2; ++k) dst[m][k] = *(const PG8_LAS bf16x8*)(lds + PG8_SA(b, h) + aoff + m * 2048 + k * 1024); } while (0)
#define PG8_LDB(dst, b, h) do { _Pragma("unroll") for (int n = 0; n < 2; ++n) _Pragma("unroll") for (int k = 0; k < 2; ++k) dst[n][k] = *(const PG8_LAS bf16x8*)(lds + PG8_SB(b, h) + boff + n * 2048 + k * 1024); } while (0)
#define PG8_MMA(ai, bj, At, Bt) do { __builtin_amdgcn_s_setprio(1); _Pragma("unroll") for (int m = 0; m < 4; ++m) _Pragma("unroll") for (int n = 0; n < 2; ++n) _Pragma("unroll") for (int k = 0; k < 2; ++k) \
        acc[ai][bj][m][n] = __builtin_amdgcn_mfma_f32_16x16x32_bf16(Bt[n][k], At[m][k], acc[ai][bj][m][n], 0, 0, 0); __builtin_amdgcn_s_setprio(0); } while (0)
#define PG8_WAIT_V(n) asm volatile("s_waitcnt vmcnt(" #n ")" ::: "memory")
#define PG8_WAIT_L(n) asm volatile("s_waitcnt lgkmcnt(" #n ")" ::: "memory")
#define PG8_BAR __builtin_amdgcn_s_barrier()
#define PG8_SCHED __builtin_amdgcn_sched_barrier(0)
    Unit cur, nxt; int ui = 0;
    if (!S.next(0, cur)) return;
    f32x4 acc[2][2][4][2];
#pragma unroll
    for (int a = 0; a < 2; ++a)
#pragma unroll
        for (int b = 0; b < 2; ++b)
#pragma unroll
            for (int m = 0; m < 4; ++m)
#pragma unroll
                for (int n = 0; n < 2; ++n) acc[a][b][m][n] = (f32x4){0.f, 0.f, 0.f, 0.f};
    bf16x8 At[4][2], B0[2][2], B1[2][2];
    const char* cA = (const char*)g.A + (size_t)cur.pm * tstep; const char* cB = (const char*)g.Bt + (size_t)cur.pn * tstep;
    S.a_ready(cur);
    if constexpr (SP2) {
        PG8_STAGE(PG8_SB(0, 0), cB, voffB); PG8_STAGE(PG8_SB(0, 1), cB + hstep, voffB); PG8_STAGE(PG8_SA(0, 0), cA, voffA); PG8_STAGE(PG8_SA(0, 1), cA + hstep, voffA);
        if (wr == 1) PG8_BAR;
        PG8_WAIT_V(2); PG8_BAR;
        PG8_STAGE(PG8_SB(1, 0), cB + kstep, voffB); PG8_STAGE(PG8_SA(1, 0), cA + kstep, voffA); PG8_STAGE(PG8_SB(1, 1), cB + hstep + kstep, voffB);
        PG8_WAIT_V(6); PG8_BAR;
    } else {
        PG8_STAGE(PG8_SB(0, 0), cB, voffB); PG8_STAGE(PG8_SA(0, 0), cA, voffA); PG8_STAGE(PG8_SB(0, 1), cB + hstep, voffB); PG8_STAGE(PG8_SA(0, 1), cA + hstep, voffA);
        if (wr == 1) PG8_BAR;
        PG8_WAIT_V(4); PG8_BAR;
        PG8_STAGE(PG8_SB(1, 0), cB + kstep, voffB); PG8_STAGE(PG8_SA(1, 0), cA + kstep, voffA); PG8_STAGE(PG8_SB(1, 1), cB + hstep + kstep, voffB);
        PG8_WAIT_V(6); PG8_BAR;
    }
    for (;;) {
        const bool has_next = S.next(ui + 1, nxt);
        const char* nA = has_next ? (const char*)g.A + (size_t)nxt.pm * tstep : cA; const char* nB = has_next ? (const char*)g.Bt + (size_t)nxt.pn * tstep : cB;
        for (int t = 0; t < nt; t += 2) {
            const bool last = (t == nt - 2);
            const char* a1 = cA + (size_t)(t + 1) * kstep;
            const char* a2 = last ? nA : cA + (size_t)(t + 2) * kstep; const char* b2 = last ? nB : cB + (size_t)(t + 2) * kstep;
            const char* a3 = a2 + kstep; const char* b3 = b2 + kstep;
            if (last && has_next) S.a_ready(nxt);
            if constexpr (SP2) {
            PG8_LDB(B0, 0, 0); PG8_LDB(B1, 0, 1); PG8_SCHED; PG8_LDA(At, 0, 0); PG8_STAGE(PG8_SA(1, 1), a1 + hstep, voffA);
            PG8_WAIT_V(8); PG8_WAIT_L(0); PG8_BAR; PG8_MMA(0, 0, At, B0); PG8_MMA(0, 1, At, B1); PG8_BAR; PG8_SCHED;
            PG8_LDA(At, 0, 1); PG8_STAGE(PG8_SB(0, 0), b2, voffB); PG8_STAGE(PG8_SB(0, 1), b2 + hstep, voffB); PG8_STAGE(PG8_SA(0, 0), a2, voffA);
            PG8_WAIT_V(8); PG8_WAIT_L(0); PG8_BAR; PG8_MMA(1, 0, At, B0); PG8_MMA(1, 1, At, B1); PG8_BAR; PG8_SCHED;
            PG8_LDB(B0, 1, 0); PG8_LDB(B1, 1, 1); PG8_SCHED; PG8_LDA(At, 1, 0); PG8_STAGE(PG8_SA(0, 1), a2 + hstep, voffA);
            PG8_WAIT_V(8); PG8_WAIT_L(0); PG8_BAR; PG8_MMA(0, 0, At, B0); PG8_MMA(0, 1, At, B1); PG8_BAR; PG8_SCHED;
            PG8_LDA(At, 1, 1); PG8_STAGE(PG8_SB(1, 0), b3, voffB); PG8_STAGE(PG8_SB(1, 1), b3 + hstep, voffB); PG8_STAGE(PG8_SA(1, 0), a3, voffA);
            PG8_WAIT_V(8); PG8_WAIT_L(0); PG8_BAR; PG8_MMA(1, 0, At, B0); PG8_MMA(1, 1, At, B1); PG8_BAR; PG8_SCHED;
            } else {
            PG8_LDB(B0, 0, 0); PG8_SCHED; PG8_LDA(At, 0, 0); PG8_STAGE(PG8_SA(1, 1), a1 + hstep, voffA);
            PG8_WAIT_L(8); PG8_BAR; PG8_WAIT_L(0); PG8_MMA(0, 0, At, B0); PG8_BAR; PG8_SCHED;
            PG8_LDB(B1, 0, 1); PG8_STAGE(PG8_SB(0, 0), b2, voffB);
            PG8_BAR; PG8_WAIT_L(0); PG8_MMA(0, 1, At, B1); PG8_BAR;
            PG8_LDA(At, 0, 1); PG8_STAGE(PG8_SA(0, 0), a2, voffA);
            PG8_BAR; PG8_WAIT_L(0); PG8_MMA(1, 0, At, B0); PG8_BAR; PG8_SCHED;
            PG8_STAGE(PG8_SB(0, 1), b2 + hstep, voffB);
            PG8_WAIT_V(6); PG8_BAR; PG8_MMA(1, 1, At, B1); PG8_BAR;
            PG8_LDB(B0, 1, 0); PG8_SCHED; PG8_LDA(At, 1, 0); PG8_STAGE(PG8_SA(0, 1), a2 + hstep, voffA);
            PG8_WAIT_L(8); PG8_BAR; PG8_WAIT_L(0); PG8_MMA(0, 0, At, B0); PG8_BAR; PG8_SCHED;
            PG8_LDB(B1, 1, 1); PG8_STAGE(PG8_SB(1, 0), b3, voffB);
            PG8_BAR; PG8_WAIT_L(0); PG8_MMA(0, 1, At, B1); PG8_BAR;
            PG8_LDA(At, 1, 1); PG8_STAGE(PG8_SA(1, 0), a3, voffA);
            PG8_BAR; PG8_WAIT_L(0); PG8_MMA(1, 0, At, B0); PG8_BAR; PG8_SCHED;
            PG8_STAGE(PG8_SB(1, 1), b3 + hstep, voffB);
            PG8_WAIT_V(6); PG8_BAR; PG8_MMA(1, 1, At, B1); PG8_BAR;
            }
        }
        if constexpr (ALIGN_EPI) { if (wr == 0) PG8_BAR; }
        if constexpr (!Epi::AFTER_DRAIN) { E(acc, cur, wr, wc, fr, fq); S.done(cur); }
        if (!has_next) break;
#pragma unroll
        for (int a = 0; a < 2; ++a)
#pragma unroll
            for (int b = 0; b < 2; ++b)
#pragma unroll
                for (int m = 0; m < 4; ++m)
#pragma unroll
                    for (int n = 0; n < 2; ++n) acc[a][b][m][n] = (f32x4){0.f, 0.f, 0.f, 0.f};
        cur = nxt; cA = nA; cB = nB; ++ui;
        if constexpr (ALIGN_EPI) { if (wr == 1) PG8_BAR; }
    }
    PG8_WAIT_V(0);
    if constexpr (!ALIGN_EPI) { if (wr == 0) PG8_BAR; }
    PG8_BAR;
    if constexpr (Epi::AFTER_DRAIN) { E.fused(acc, cur, wr, wc, fr, fq, lds, wid, lane); S.done(cur); }
#undef PG8_SA
#undef PG8_SB
#undef PG8_STAGE
#undef PG8_LDA
#undef PG8_LDB
#undef PG8_MMA
#undef PG8_WAIT_V
#undef PG8_WAIT_L
#undef PG8_BAR
#undef PG8_SCHED
}
}
constexpr int NWAVES = 8;
constexpr int DM = 1024;
constexpr int M_PROMPT = 8 * 2048, M_SAMPLE = 4 * 8192, M = M_PROMPT + M_SAMPLE;
constexpr int D_IN = 3104, N1 = 3072;
constexpr int NCHUNK = M / 128;
constexpr int NUNIT = NCHUNK * 4;
constexpr float EPS = 1e-6f;
constexpr float LOG2E = 1.4426950408889634f;

constexpr size_t MiB = 1u << 20;
constexpr size_t WS_CTL = 0, CTL_ZERO_BYTES = 64 * 1024;
constexpr size_t WS_W1T = 2 * MiB;
constexpr size_t WS_W2T = 8 * MiB;
constexpr size_t WS_WSP = 10 * MiB;
constexpr size_t WS_LR = 11 * MiB;
constexpr size_t WS_VSTAT = 17 * MiB;
constexpr size_t WS_DEC = 20 * MiB;
constexpr size_t WS_SS = 21 * MiB;
constexpr size_t WS_XB = 32 * MiB;
constexpr size_t WS_PA = 128 * MiB;
constexpr size_t WS_PB = 272 * MiB;
constexpr size_t WS_KV = 416 * MiB;
constexpr size_t WS_END = 464 * MiB;
constexpr int CW_BAR = 4096;

constexpr int RA = 0, RB = 73728, RC = 147456;
constexpr int P64 = 144, P128 = 272;
constexpr int IMG64 = 128 * P64;
constexpr int IMG128 = 128 * P128;
constexpr int RC_TOT = RC, RC_SEG = RC + 512, RC_MS = RC + 2560;
constexpr int MISC_OFF = RC + 3584;
constexpr int LDS_BYTES = MISC_OFF + 512;
static_assert(RA + 4 * IMG64 <= RB && RB + 2 * IMG128 <= RC && RB + 65536 <= RC && pg8::STAGE_BYTES <= RC, "LDS map");

#define GAS __attribute__((address_space(1)))
#define LAS __attribute__((address_space(3)))
typedef unsigned short bf16;
typedef unsigned v4u __attribute__((ext_vector_type(4)));
typedef unsigned v2u __attribute__((ext_vector_type(2)));
typedef float f32x4 __attribute__((ext_vector_type(4)));
typedef short bf16x8 __attribute__((ext_vector_type(8)));
typedef short v4i16 __attribute__((ext_vector_type(4)));
typedef GAS unsigned gu32;
#define RLX_AGENT __ATOMIC_RELAXED, __HIP_MEMORY_SCOPE_AGENT
#define LDS_WAIT() asm volatile("s_waitcnt lgkmcnt(0)" ::: "memory")
__device__ __forceinline__ unsigned f2bf(float f) { unsigned u = __builtin_bit_cast(unsigned, f); return (u + 0x7fffu + ((u >> 16) & 1u)) >> 16; }
typedef float f32x2_t __attribute__((ext_vector_type(2))); typedef __bf16 bf16x2_t __attribute__((ext_vector_type(2)));
__device__ __forceinline__ unsigned pk2c(float lo, float hi) { f32x2_t v = {lo, hi}; bf16x2_t b = __builtin_convertvector(v, bf16x2_t); return __builtin_bit_cast(unsigned, b); }
__device__ __forceinline__ unsigned pk2(float lo, float hi) { return pg8::cvt_pk_bf16(lo, hi); }
__device__ __forceinline__ float bflo(unsigned w) { return __builtin_bit_cast(float, w << 16); }
__device__ __forceinline__ float bfhi(unsigned w) { return __builtin_bit_cast(float, w & 0xffff0000u); }
__device__ __forceinline__ float ex2(float x) { return __builtin_amdgcn_exp2f(x); }
__device__ __forceinline__ float wave_sum(float v) {
#pragma unroll
    for (int o = 1; o < 64; o <<= 1) v += __shfl_xor(v, o);
    return v;
}
__device__ __forceinline__ bf16x8 tr_frag(LAS unsigned char* p, int pitch) {
    const v4i16 a = __builtin_amdgcn_ds_read_tr16_b64_v4i16((LAS v4i16*)p);
    const v4i16 b = __builtin_amdgcn_ds_read_tr16_b64_v4i16((LAS v4i16*)(p + 4 * pitch));
    return (bf16x8){a[0], a[1], a[2], a[3], b[0], b[1], b[2], b[3]};
}
#define MFMA16(a, b, c) __builtin_amdgcn_mfma_f32_16x16x32_bf16((a), (b), (c), 0, 0, 0)

#define XB_TMO      128
#define XB_XCNT(j)  (256  + 64 * (j))
#define XB_XSUB(j)  (1280 + 64 * (j))
#define XB_XGEN(j)  (2304 + 64 * (j))
#define XB_TOP      3328
#define XB_TOPGEN   3392
#define XCD_BAR_WORDS 3456
#define XB_SPIN_CAP (1u << 18)

__device__ __forceinline__ unsigned xb_ld(unsigned* p)              { return __hip_atomic_load(p, __ATOMIC_RELAXED, __HIP_MEMORY_SCOPE_AGENT); }
__device__ __forceinline__ unsigned xb_add(unsigned* p, unsigned v) { return __hip_atomic_fetch_add(p, v, __ATOMIC_RELAXED, __HIP_MEMORY_SCOPE_AGENT); }
__device__ __forceinline__ unsigned xb_xcc_id() { return (unsigned)__builtin_amdgcn_s_getreg((3 << 11) | 20) & 0xFu; }
#define XB_SPIN(cond, bar) do { unsigned _sp = 0; while (cond) { __builtin_amdgcn_s_sleep(1); \
    if ((++_sp & 255u) == 0u) { if (xb_ld(&(bar)[XB_TMO])) break; if (_sp > XB_SPIN_CAP) { atomicAdd(&(bar)[XB_TMO], 1u); break; } } } } while (0)

struct XcdBarrier {
    unsigned* bar; unsigned x;
    volatile LAS unsigned* st;
};

__device__ __forceinline__ XcdBarrier xcd_barrier_post(unsigned* bar, volatile LAS unsigned* st) {
    XcdBarrier b; b.bar = bar; b.x = xb_xcc_id(); b.st = st;
    if (threadIdx.x == 0) (void)xb_add(&bar[XB_XCNT(b.x)], 1u);
    return b;
}
__device__ __forceinline__ void xcd_barrier_complete(unsigned* bar, unsigned x, unsigned& nloc, unsigned& nx) {
    const unsigned G = gridDim.x * gridDim.y * gridDim.z;
    unsigned sum, cnt, mine, sp = 0u;
    for (;;) {
        sum = 0u; cnt = 0u; mine = 0u;
#pragma unroll
        for (unsigned j = 0; j < 16; ++j) { const unsigned c = xb_ld(&bar[XB_XCNT(j)]); sum += c; cnt += (c > 0u) ? 1u : 0u; mine = (j == x) ? c : mine; }
        if (sum == G) break;
        __builtin_amdgcn_s_sleep(1);
        if ((++sp & 255u) == 0u) { if (xb_ld(&bar[XB_TMO])) break; if (sp > XB_SPIN_CAP) { atomicAdd(&bar[XB_TMO], 1u); break; } }
    }
    nloc = mine > 0u ? mine : 1u; nx = cnt > 0u ? cnt : 1u;
}

__device__ __forceinline__ void xcd_barrier(const XcdBarrier& b) {
    asm volatile("s_waitcnt vmcnt(0)" ::: "memory");
    __syncthreads();
    if (threadIdx.x == 0) {
        unsigned* bar = b.bar;
        __builtin_amdgcn_s_waitcnt(0);
        unsigned nloc = b.st[0], nx = b.st[1];
        if (nloc == 0u) { xcd_barrier_complete(bar, b.x, nloc, nx); b.st[0] = nloc; b.st[1] = nx; }
        const unsigned old = xb_add(&bar[XB_XSUB(b.x)], 1u);
        const unsigned gen = old / nloc;
        if (old + 1u == (gen + 1u) * nloc) {
            __builtin_amdgcn_fence(__ATOMIC_RELEASE, "agent");
            asm volatile("s_waitcnt vmcnt(0)" ::: "memory");
            const unsigned og = xb_add(&bar[XB_TOP], 1u);
            const unsigned tg = og / nx;
            if (og + 1u == (tg + 1u) * nx) xb_add(&bar[XB_TOPGEN], 1u);
            else XB_SPIN(xb_ld(&bar[XB_TOPGEN]) == tg, bar);
            __builtin_amdgcn_fence(__ATOMIC_ACQUIRE, "agent");
            xb_add(&bar[XB_XGEN(b.x)], 1u);
            asm volatile("s_waitcnt vmcnt(0)" ::: "memory");
        } else {
            XB_SPIN(xb_ld(&bar[XB_XGEN(b.x)]) == gen, bar);
            __builtin_amdgcn_fence(__ATOMIC_ACQUIRE, "agent");
            asm volatile("s_waitcnt vmcnt(0)" ::: "memory");
        }
    }
    __syncthreads();
}


struct Args {
    const float* xp; const float* xs; const float* norm_pre; const float* w_in; const float* w_sp; const float* b_sp; const float* g_v_a;
    const float* w_gk_f; const float* b_gk_f; const float* w_gk_b; const float* b_gk_b; const float* g_norm_b; const float* w_out; const float* norm_post;
    float* out; unsigned char* ws;
};
__device__ __forceinline__ const float* xrow_ptr(const Args& a, int m) { return m < M_PROMPT ? a.xp + (size_t)m * DM : a.xs + (size_t)(m - M_PROMPT) * DM; }

__device__ __forceinline__ void p0_transpose_item(const float* W, int ldw, int ncolblk, const float* gs, bf16* WT, int K, LAS float* scr, int item, int lane) {
    const int kb = item / ncolblk, nb = item % ncolblk, k0 = 64 * kb, n0 = 32 * nb;
#pragma unroll 8
    for (int i = 0; i < 32; ++i) { const int kk = 2 * i + (lane >> 5); float v = W[(size_t)(k0 + kk) * ldw + n0 + (lane & 31)]; if (gs) v *= gs[k0 + kk]; scr[kk * 33 + (lane & 31)] = v; }
    LDS_WAIT(); asm volatile("" ::: "memory");
    const int c = lane & 7;
#pragma unroll
    for (int j = 0; j < 4; ++j) { const int n = (lane >> 3) + 8 * j; const LAS float* s = scr + (8 * c) * 33 + n;
        v4u o; o.x = pk2(s[0 * 33], s[1 * 33]); o.y = pk2(s[2 * 33], s[3 * 33]); o.z = pk2(s[4 * 33], s[5 * 33]); o.w = pk2(s[6 * 33], s[7 * 33]);
        *(v4u*)(WT + (size_t)(n0 + n) * K + k0 + 8 * c) = o; }
    LDS_WAIT(); asm volatile("" ::: "memory");
}
constexpr int WLP = 1028;
__device__ __forceinline__ void p0_prologue(const Args& a, LAS unsigned char* lds, int vcu, int tid, int lane, int wave) {
    unsigned char* ws = a.ws;
    bf16* W1T = (bf16*)(ws + WS_W1T); bf16* W2T = (bf16*)(ws + WS_W2T); bf16* WSP = (bf16*)(ws + WS_WSP);
    const int gw = vcu * NWAVES + wave, NGW = 256 * NWAVES;
    {
        LAS float* scr = (LAS float*)(lds + wave * 16384);
        constexpr int I1 = (DM / 64) * (N1 / 32), I2 = (DM / 64) * (DM / 32);
        for (int it = gw; it < I1 + I2; it += NGW) {
            if (it < I1) p0_transpose_item(a.w_in, D_IN, N1 / 32, a.norm_pre, W1T, DM, scr, it, lane);
            else p0_transpose_item(a.w_out, DM, DM / 32, nullptr, W2T, DM, scr, it - I1, lane);
        }
        for (int i = vcu * 512 + tid; i < 4 * 128 * 128 / 4; i += 256 * 512) { const f32x4 v = ((const f32x4*)a.w_sp)[i]; v2u o; o.x = pk2(v[0], v[1]); o.y = pk2(v[2], v[3]); ((v2u*)WSP)[i] = o; }
    }
    __syncthreads();
    LAS float* wl = (LAS float*)lds;
    for (int idx = tid; idx < 32 * DM; idx += 512) { const int k = idx >> 5, n = idx & 31; wl[n * WLP + k] = a.w_in[(size_t)k * D_IN + N1 + n] * a.norm_pre[k]; }
    __syncthreads();
    bf16* XB = (bf16*)(ws + WS_XB); float* LR = (float*)(ws + WS_LR);
    for (int pr = gw; pr < M / 2; pr += NGW) {
        const int m0 = 2 * pr;
        const f32x4* x0 = (const f32x4*)xrow_ptr(a, m0) + lane; const f32x4* x1 = (const f32x4*)xrow_ptr(a, m0 + 1) + lane;
        f32x4 v0[4], v1[4]; float s0 = 0.f, s1 = 0.f;
#pragma unroll
        for (int j = 0; j < 4; ++j) { v0[j] = x0[64 * j]; v1[j] = x1[64 * j]; }
#pragma unroll
        for (int j = 0; j < 4; ++j) { s0 += (v0[j][0] * v0[j][0] + v0[j][1] * v0[j][1]) + (v0[j][2] * v0[j][2] + v0[j][3] * v0[j][3]); s1 += (v1[j][0] * v1[j][0] + v1[j][1] * v1[j][1]) + (v1[j][2] * v1[j][2] + v1[j][3] * v1[j][3]); }
        const float r0 = 1.0f / sqrtf(wave_sum(s0) * (1.0f / DM) + EPS), r1 = 1.0f / sqrtf(wave_sum(s1) * (1.0f / DM) + EPS);
        v2u* o0 = (v2u*)(XB + (size_t)m0 * DM) + lane; v2u* o1 = (v2u*)(XB + (size_t)(m0 + 1) * DM) + lane;
#pragma unroll
        for (int j = 0; j < 4; ++j) { v0[j] = v0[j] * r0; v1[j] = v1[j] * r1;
            v2u w; w.x = pk2(v0[j][0], v0[j][1]); w.y = pk2(v0[j][2], v0[j][3]); o0[64 * j] = w;
            w.x = pk2(v1[j][0], v1[j][1]); w.y = pk2(v1[j][2], v1[j][3]); o1[64 * j] = w; }
        float a0[32], a1[32];
#pragma unroll
        for (int n = 0; n < 32; ++n) { float p0 = 0.f, p1 = 0.f;
#pragma unroll
            for (int j = 0; j < 4; ++j) { const f32x4 w = *(const LAS f32x4*)(wl + n * WLP + 256 * j + 4 * lane);
                p0 += (v0[j][0] * w[0] + v0[j][1] * w[1]) + (v0[j][2] * w[2] + v0[j][3] * w[3]);
                p1 += (v1[j][0] * w[0] + v1[j][1] * w[1]) + (v1[j][2] * w[2] + v1[j][3] * w[3]); }
            a0[n] = p0; a1[n] = p1; }
#define RED_STAGE(CNT, MASK) _Pragma("unroll") for (int i = 0; i < CNT; ++i) { const bool hi = (lane & MASK) != 0; \
            { const float x_ = a0[i], y_ = a0[i + CNT]; const float snd = hi ? x_ : y_, kp = hi ? y_ : x_; a0[i] = kp + __shfl_xor(snd, MASK); } \
            { const float x_ = a1[i], y_ = a1[i + CNT]; const float snd = hi ? x_ : y_, kp = hi ? y_ : x_; a1[i] = kp + __shfl_xor(snd, MASK); } }
        RED_STAGE(16, 32) RED_STAGE(8, 16) RED_STAGE(4, 8) RED_STAGE(2, 4) RED_STAGE(1, 2)
#undef RED_STAGE
        a0[0] += __shfl_xor(a0[0], 1); a1[0] += __shfl_xor(a1[0], 1);
        if ((lane & 1) == 0) { LR[(size_t)m0 * 32 + (lane >> 1)] = a0[0]; LR[(size_t)(m0 + 1) * 32 + (lane >> 1)] = a1[0]; }
    }
}

__device__ __forceinline__ void p2_gates(const Args& a, LAS unsigned char* lds, int r0, int h, int tid) {
    const float* LR = (const float*)(a.ws + WS_LR);
    LAS float* LRs = (LAS float*)(lds + RA + 3 * IMG64);
    { const f32x4* src = (const f32x4*)(LR + (size_t)r0 * 32);
#pragma unroll
      for (int i = 0; i < 2; ++i) ((LAS f32x4*)LRs)[tid + 512 * i] = src[tid + 512 * i]; }
    const int ch = tid & 63, w = tid >> 6, dir = w & 1, tg = w >> 1;
    const float* wg = dir ? a.w_gk_b : a.w_gk_f; const float* bg = dir ? a.b_gk_b : a.b_gk_f;
    float wr_[16];
#pragma unroll
    for (int r = 0; r < 16; ++r) wr_[r] = wg[r * 256 + h * 64 + ch];
    const float bias = bg[h * 64 + ch];
    __syncthreads();
    LAS float* Gs = (LAS float*)(lds + RB) + dir * 8192;
    float run = 0.f;
    for (int tt = 0; tt < 32; ++tt) {
        const int t = tg * 32 + tt;
        const LAS f32x4* lp = (const LAS f32x4*)(LRs + t * 32 + dir * 16);
        const f32x4 l0 = lp[0], l1 = lp[1], l2 = lp[2], l3 = lp[3];
        float y = bias;
        y += l0[0] * wr_[0]; y += l0[1] * wr_[1]; y += l0[2] * wr_[2]; y += l0[3] * wr_[3];
        y += l1[0] * wr_[4]; y += l1[1] * wr_[5]; y += l1[2] * wr_[6]; y += l1[3] * wr_[7];
        y += l2[0] * wr_[8]; y += l2[1] * wr_[9]; y += l2[2] * wr_[10]; y += l2[3] * wr_[11];
        y += l3[0] * wr_[12]; y += l3[1] * wr_[13]; y += l3[2] * wr_[14]; y += l3[3] * wr_[15];
        const float e = ex2(-fabsf(y) * LOG2E);
        const float g = (fminf(y, 0.f) * LOG2E - __builtin_amdgcn_logf(1.0f + e)) * (1.0f / 16.0f);
        if (dir == 0) { run += g; Gs[t * 64 + ch] = run; } else { Gs[t * 64 + ch] = run; run += g; }
    }
    LAS float* SEG = (LAS float*)(lds + RC_SEG);
    SEG[(dir * 4 + tg) * 64 + ch] = run;
    __syncthreads();
    float off = 0.f, tot = 0.f;
#pragma unroll
    for (int g = 0; g < 4; ++g) { const float s = SEG[(dir * 4 + g) * 64 + ch]; if (g < tg) off += s; tot += s; }
    for (int tt = 0; tt < 32; ++tt) { const int t = tg * 32 + tt; const float v = Gs[t * 64 + ch]; Gs[t * 64 + ch] = dir ? (tot - (v + off)) : (v + off); }
    if (tg == 0) ((LAS float*)(lds + RC_TOT))[dir * 64 + ch] = tot;
    __syncthreads();
}

__device__ __forceinline__ v4u scale8(v4u raw, const LAS float* cum, const LAS float* tot, float sgn) {
    const f32x4 c0 = *(const LAS f32x4*)cum, c1 = *(const LAS f32x4*)(cum + 4);
    f32x4 t0 = {0.f, 0.f, 0.f, 0.f}, t1 = {0.f, 0.f, 0.f, 0.f};
    if (tot) { t0 = *(const LAS f32x4*)tot; t1 = *(const LAS f32x4*)(tot + 4); }
    v4u o;
    o.x = pk2(bflo(raw.x) * ex2(sgn * c0[0] + t0[0]), bfhi(raw.x) * ex2(sgn * c0[1] + t0[1]));
    o.y = pk2(bflo(raw.y) * ex2(sgn * c0[2] + t0[2]), bfhi(raw.y) * ex2(sgn * c0[3] + t0[3]));
    o.z = pk2(bflo(raw.z) * ex2(sgn * c1[0] + t1[0]), bfhi(raw.z) * ex2(sgn * c1[1] + t1[1]));
    o.w = pk2(bflo(raw.w) * ex2(sgn * c1[2] + t1[2]), bfhi(raw.w) * ex2(sgn * c1[3] + t1[3]));
    return o;
}

__device__ __forceinline__ void p2a_unit(const Args& a, LAS unsigned char* lds, int unit, int tid, int lane, int wave) {
    const int c = unit >> 2, h = unit & 3, r0 = c * 128;
    unsigned char* ws = a.ws;
    const bf16* PA = (const bf16*)(ws + WS_PA); const bf16* PB = (const bf16*)(ws + WS_PB);
    bf16* MIX = (bf16*)(ws + WS_XB); bf16* KV = (bf16*)(ws + WS_KV); float* DEC = (float*)(ws + WS_DEC);
    const float* VSTAT = (const float*)(ws + WS_VSTAT); const bf16* WSP = (const bf16*)(ws + WS_WSP);
    p2_gates(a, lds, r0, h, tid);
    const LAS float* TOT = (const LAS float*)(lds + RC_TOT);
#pragma unroll
    for (int i = 0; i < 2; ++i) { const int p = tid + 512 * i, j = p >> 3, dg = p & 7;
        const v4u kraw = *(const v4u*)(PB + (size_t)(r0 + j) * 1536 + 256 + h * 64 + dg * 8);
#pragma unroll
        for (int dir = 0; dir < 2; ++dir)
            *(LAS v4u*)(lds + RA + dir * IMG64 + j * P64 + dg * 16) = scale8(kraw, (const LAS float*)(lds + RB) + dir * 8192 + j * 64 + dg * 8, TOT + dir * 64 + dg * 8, -1.0f); }
#pragma unroll
    for (int i = 0; i < 4; ++i) { const int p = tid + 512 * i, j = p >> 4, eg = p & 15;
        *(LAS v4u*)(lds + RA + 2 * IMG64 + j * P128 + eg * 16) = *(const v4u*)(PB + (size_t)(r0 + j) * 1536 + 512 + h * 128 + eg * 8); }
    LAS float* MS = (LAS float*)(lds + RC_MS);
    if (tid < 128) { const float* vs = VSTAT + (size_t)(r0 + tid) * 16; float s = 0.f, ss = 0.f;
#pragma unroll
        for (int i = 0; i < 8; ++i) { s += vs[2 * i]; ss += vs[2 * i + 1]; }
        const float mean = s * (1.0f / 512.0f), var = ss * (1.0f / 512.0f) - mean * mean;
        MS[2 * tid] = mean; MS[2 * tid + 1] = 1.0f / sqrtf(var + EPS);
        DEC[(size_t)unit * 128 + tid] = ex2(TOT[tid]); }
    __syncthreads();
#pragma unroll
    for (int i = 0; i < 4; ++i) { const int p = tid + 512 * i, j = p >> 4, cg = p & 15;
        const v4u raw = *(const v4u*)(PA + (size_t)(r0 + j) * 1536 + 512 + h * 128 + cg * 8);
        const f32x4 g0 = *(const f32x4*)(a.g_v_a + h * 128 + cg * 8), g1 = *(const f32x4*)(a.g_v_a + h * 128 + cg * 8 + 4);
        const float mean = MS[2 * j], rs = MS[2 * j + 1];
        v4u o;
        o.x = pk2((bflo(raw.x) - mean) * rs * g0[0], (bfhi(raw.x) - mean) * rs * g0[1]);
        o.y = pk2((bflo(raw.y) - mean) * rs * g0[2], (bfhi(raw.y) - mean) * rs * g0[3]);
        o.z = pk2((bflo(raw.z) - mean) * rs * g1[0], (bfhi(raw.z) - mean) * rs * g1[1]);
        o.w = pk2((bflo(raw.w) - mean) * rs * g1[2], (bfhi(raw.w) - mean) * rs * g1[3]);
        *(LAS v4u*)(lds + RB + j * P128 + cg * 16) = o; }
    const int g = lane >> 4, q = (lane & 15) >> 2, p4 = lane & 3, li = lane & 15;
    const int trrow = 8 * g + q;
    {
        bf16x8 fv[4];
#pragma unroll
        for (int ks = 0; ks < 4; ++ks) fv[ks] = tr_frag(lds + RA + 2 * IMG64 + (32 * ks + trrow) * P128 + (16 * wave + 4 * p4) * 2, P128);
#pragma unroll
        for (int dir = 0; dir < 2; ++dir)
#pragma unroll
            for (int dt = 0; dt < 4; ++dt) {
                f32x4 acc = {0.f, 0.f, 0.f, 0.f};
#pragma unroll
                for (int ks = 0; ks < 4; ++ks) { const bf16x8 fk = tr_frag(lds + RA + dir * IMG64 + (32 * ks + trrow) * P64 + (16 * dt + 4 * p4) * 2, P64); acc = MFMA16(fk, fv[ks], acc); }
                v2u o; o.x = pk2c(acc[0], acc[1]); o.y = pk2c(acc[2], acc[3]);
                *(v2u*)(KV + ((size_t)(unit * 2 + dir) * 128 + 16 * wave + li) * 64 + 16 * dt + 4 * g) = o;
            }
    }
    __syncthreads();
    {
        bf16x8 fw[4];
#pragma unroll
        for (int ks = 0; ks < 4; ++ks) fw[ks] = *(const bf16x8*)(WSP + ((size_t)(h * 128 + 16 * wave + li) * 128 + 32 * ks + 8 * g));
        const int tok = r0 + 16 * wave + li;
        const float bsp = a.b_sp[h * 128 + 16 * wave + li];
#pragma unroll
        for (int ct = 0; ct < 8; ++ct) {
            f32x4 acc = {0.f, 0.f, 0.f, 0.f};
#pragma unroll
            for (int ks = 0; ks < 4; ++ks) { const bf16x8 fvn = tr_frag(lds + RB + (32 * ks + trrow) * P128 + (16 * ct + 4 * p4) * 2, P128); acc = MFMA16(fvn, fw[ks], acc); }
            const int ch = 16 * ct + 4 * g;
            const v2u u4 = *(const v2u*)(PA + (size_t)tok * 1536 + h * 128 + ch), z4 = *(const v2u*)(PA + (size_t)tok * 1536 + 1024 + h * 128 + ch);
            v2u o;
            o.x = pk2(bflo(u4.x) * (acc[0] + bsp) * bflo(z4.x), bfhi(u4.x) * (acc[1] + bsp) * bfhi(z4.x));
            o.y = pk2(bflo(u4.y) * (acc[2] + bsp) * bflo(z4.y), bfhi(u4.y) * (acc[3] + bsp) * bfhi(z4.y));
            *(v2u*)(MIX + (size_t)tok * 1024 + h * 128 + ch) = o;
        }
    }
    __syncthreads();
}

__device__ __forceinline__ void p2b_scan(const Args& a, int bx, int tid) {
    bf16* KV = (bf16*)(a.ws + WS_KV); const float* DEC = (const float*)(a.ws + WS_DEC);
    int shd, el, nck, chunk0;
    if (tid < 128) { const int sl = bx * 128 + tid; shd = sl >> 10; el = sl & 1023; nck = 64; chunk0 = 128 + 64 * (shd >> 3); }
    else if (tid < 384) { const int pl = bx * 256 + (tid - 128); shd = pl >> 10; el = pl & 1023; nck = 16; chunk0 = 16 * (shd >> 3); }
    else return;
    const int h = (shd >> 1) & 3, dir = shd & 1, e = el >> 3, dg = el & 7;
    float st[8];
#pragma unroll
    for (int i = 0; i < 8; ++i) st[i] = 0.f;
    v4u kv[2][4]; f32x4 d0[2][4], d1[2][4];
#define P2B_LOAD(buf, n0) _Pragma("unroll") for (int s_ = 0; s_ < 4; ++s_) { const int n_ = (n0) + s_; const int ck_ = dir ? chunk0 + nck - 1 - n_ : chunk0 + n_; const size_t ud_ = (size_t)(ck_ * 4 + h) * 2 + dir; \
        kv[buf][s_] = *(const v4u*)(KV + (ud_ * 128 + e) * 64 + dg * 8); d0[buf][s_] = *(const f32x4*)(DEC + ud_ * 64 + dg * 8); d1[buf][s_] = *(const f32x4*)(DEC + ud_ * 64 + dg * 8 + 4); }
#define P2B_STEP(buf, n0) _Pragma("unroll") for (int s_ = 0; s_ < 4; ++s_) { const int n_ = (n0) + s_; const int ck_ = dir ? chunk0 + nck - 1 - n_ : chunk0 + n_; const size_t ud_ = (size_t)(ck_ * 4 + h) * 2 + dir; \
        v4u o_; o_.x = pk2(st[0], st[1]); o_.y = pk2(st[2], st[3]); o_.z = pk2(st[4], st[5]); o_.w = pk2(st[6], st[7]); *(v4u*)(KV + (ud_ * 128 + e) * 64 + dg * 8) = o_; \
        const v4u k_ = kv[buf][s_]; const f32x4 a_ = d0[buf][s_], b_ = d1[buf][s_]; \
        st[0] = st[0] * a_[0] + bflo(k_.x); st[1] = st[1] * a_[1] + bfhi(k_.x); st[2] = st[2] * a_[2] + bflo(k_.y); st[3] = st[3] * a_[3] + bfhi(k_.y); \
        st[4] = st[4] * b_[0] + bflo(k_.z); st[5] = st[5] * b_[1] + bfhi(k_.z); st[6] = st[6] * b_[2] + bflo(k_.w); st[7] = st[7] * b_[3] + bfhi(k_.w); }
    P2B_LOAD(0, 0)
    for (int n = 0; n < nck; n += 8) {
        P2B_LOAD(1, n + 4)
        P2B_STEP(0, n)
        if (n + 8 < nck) { P2B_LOAD(0, n + 8) }
        P2B_STEP(1, n + 4)
    }
#undef P2B_LOAD
#undef P2B_STEP
}

__device__ __forceinline__ void p2c_unit(const Args& a, LAS unsigned char* lds, int unit, int tid, int lane, int wave) {
    const int c = unit >> 2, h = unit & 3, r0 = c * 128;
    unsigned char* ws = a.ws;
    const bf16* PB = (const bf16*)(ws + WS_PB); bf16* MIX = (bf16*)(ws + WS_XB); const bf16* KV = (const bf16*)(ws + WS_KV);
    p2_gates(a, lds, r0, h, tid);
#pragma unroll
    for (int i = 0; i < 2; ++i) { const int p = tid + 512 * i, j = p >> 3, dg = p & 7;
        const v4u qraw = *(const v4u*)(PB + (size_t)(r0 + j) * 1536 + h * 64 + dg * 8), kraw = *(const v4u*)(PB + (size_t)(r0 + j) * 1536 + 256 + h * 64 + dg * 8);
#pragma unroll
        for (int dir = 0; dir < 2; ++dir) { const LAS float* cum = (const LAS float*)(lds + RB) + dir * 8192 + j * 64 + dg * 8;
            *(LAS v4u*)(lds + RA + dir * IMG64 + j * P64 + dg * 16) = scale8(qraw, cum, nullptr, 1.0f);
            *(LAS v4u*)(lds + RA + (2 + dir) * IMG64 + j * P64 + dg * 16) = scale8(kraw, cum, nullptr, -1.0f); } }
    __syncthreads();
#pragma unroll
    for (int i = 0; i < 4; ++i) { const int p = tid + 512 * i, j = p >> 4, eg = p & 15;
        *(LAS v4u*)(lds + RB + IMG128 + j * P128 + eg * 16) = *(const v4u*)(PB + (size_t)(r0 + j) * 1536 + 512 + h * 128 + eg * 8); }
    const int g = lane >> 4, q = (lane & 15) >> 2, p4 = lane & 3, li = lane & 15;
    const int trrow = 8 * g + q;
    bf16x8 fqf[2], fqb[2];
#pragma unroll
    for (int ks = 0; ks < 2; ++ks) { fqf[ks] = *(const LAS bf16x8*)(lds + RA + (16 * wave + li) * P64 + (32 * ks + 8 * g) * 2); fqb[ks] = *(const LAS bf16x8*)(lds + RA + IMG64 + (16 * wave + li) * P64 + (32 * ks + 8 * g) * 2); }
    const int tt = 16 * wave + li;
#pragma unroll
    for (int jt = 0; jt < 8; ++jt) {
        f32x4 af = {0.f, 0.f, 0.f, 0.f}, ab = {0.f, 0.f, 0.f, 0.f};
        if (jt <= wave) {
#pragma unroll
            for (int ks = 0; ks < 2; ++ks) { const bf16x8 fk = *(const LAS bf16x8*)(lds + RA + 2 * IMG64 + (16 * jt + li) * P64 + (32 * ks + 8 * g) * 2); af = MFMA16(fk, fqf[ks], af); } }
        if (jt >= wave) {
#pragma unroll
            for (int ks = 0; ks < 2; ++ks) { const bf16x8 fk = *(const LAS bf16x8*)(lds + RA + 3 * IMG64 + (16 * jt + li) * P64 + (32 * ks + 8 * g) * 2); ab = MFMA16(fk, fqb[ks], ab); } }
        const int jj = 16 * jt + 4 * g;
        v2u o; o.x = pk2(tt >= jj ? af[0] : ab[0], tt >= jj + 1 ? af[1] : ab[1]); o.y = pk2(tt >= jj + 2 ? af[2] : ab[2], tt >= jj + 3 ? af[3] : ab[3]);
        *(LAS v2u*)(lds + RB + tt * P128 + jj * 2) = o;
    }
    __syncthreads();
#pragma unroll
    for (int dir = 0; dir < 2; ++dir)
#pragma unroll
        for (int i = 0; i < 2; ++i) { const int p = tid + 512 * i, e = p >> 3, dg = p & 7;
            *(LAS v4u*)(lds + RA + (2 + dir) * IMG64 + e * P64 + dg * 16) = *(const v4u*)(KV + ((size_t)(unit * 2 + dir) * 128 + e) * 64 + dg * 8); }
    __syncthreads();
    bf16x8 fp[4];
#pragma unroll
    for (int ks = 0; ks < 4; ++ks) fp[ks] = *(const LAS bf16x8*)(lds + RB + tt * P128 + (32 * ks + 8 * g) * 2);
    f32x4 o[8]; float ss = 0.f;
#pragma unroll
    for (int et = 0; et < 8; ++et) {
        f32x4 acc = {0.f, 0.f, 0.f, 0.f};
#pragma unroll
        for (int ks = 0; ks < 4; ++ks) { const bf16x8 fv = tr_frag(lds + RB + IMG128 + (32 * ks + trrow) * P128 + (16 * et + 4 * p4) * 2, P128); acc = MFMA16(fv, fp[ks], acc); }
#pragma unroll
        for (int ks = 0; ks < 2; ++ks) { const bf16x8 fs = *(const LAS bf16x8*)(lds + RA + 2 * IMG64 + (16 * et + li) * P64 + (32 * ks + 8 * g) * 2); acc = MFMA16(fs, fqf[ks], acc); }
#pragma unroll
        for (int ks = 0; ks < 2; ++ks) { const bf16x8 fs = *(const LAS bf16x8*)(lds + RA + 3 * IMG64 + (16 * et + li) * P64 + (32 * ks + 8 * g) * 2); acc = MFMA16(fs, fqb[ks], acc); }
        o[et] = acc; ss += (acc[0] * acc[0] + acc[1] * acc[1]) + (acc[2] * acc[2] + acc[3] * acc[3]);
    }
    ss += __shfl_xor(ss, 16); ss += __shfl_xor(ss, 32);
    const float rs = 1.0f / sqrtf(ss * (1.0f / 128.0f) + EPS);
    const int tok = r0 + tt;
#pragma unroll
    for (int et = 0; et < 8; ++et) { const int e = 16 * et + 4 * g;
        const f32x4 gn = *(const f32x4*)(a.g_norm_b + e);
        const v2u z4 = *(const v2u*)(PB + (size_t)tok * 1536 + 1024 + h * 128 + e);
        v2u w; w.x = pk2(o[et][0] * rs * gn[0] * bflo(z4.x), o[et][1] * rs * gn[1] * bfhi(z4.x)); w.y = pk2(o[et][2] * rs * gn[2] * bflo(z4.y), o[et][3] * rs * gn[3] * bfhi(z4.y));
        *(v2u*)(MIX + (size_t)tok * 1024 + 512 + h * 128 + e) = w; }
    __syncthreads();
}

__device__ __forceinline__ void p4_final(const Args& a, int vcu, int lane, int wave) {
    const float* MIXED = (const float*)(a.ws + WS_PA); const float* SS = (const float*)(a.ws + WS_SS);
    const int gw = vcu * NWAVES + wave, NGW = 256 * NWAVES;
    f32x4 gp[4];
#pragma unroll
    for (int j = 0; j < 4; ++j) gp[j] = ((const f32x4*)a.norm_post)[lane + 64 * j];
    for (int m = gw; m < M; m += NGW) {
        float s = lane < 16 ? SS[(size_t)m * 16 + lane] : 0.f;
        s = wave_sum(s);
        const float rs = 1.0f / sqrtf(s * (1.0f / DM) + EPS);
        const f32x4* xr = (const f32x4*)xrow_ptr(a, m) + lane; const f32x4* mr = (const f32x4*)(MIXED + (size_t)m * DM) + lane; f32x4* orow = (f32x4*)(a.out + (size_t)m * DM) + lane;
#pragma unroll
        for (int j = 0; j < 4; ++j) orow[64 * j] = xr[64 * j] + mr[64 * j] * rs * gp[j];
    }
}


#ifndef DBG_STAGE
#define DBG_STAGE 0
#endif
__device__ __forceinline__ void dbg_dump(const Args& a, int stage, int bx, int tid) {
    unsigned char* ws = a.ws;
    const bf16* PA = (const bf16*)(ws + WS_PA); const bf16* PB = (const bf16*)(ws + WS_PB); const bf16* MIX = (const bf16*)(ws + WS_XB); const bf16* KV = (const bf16*)(ws + WS_KV);
    const float* LR = (const float*)(ws + WS_LR); const float* VSTAT = (const float*)(ws + WS_VSTAT); const float* DEC = (const float*)(ws + WS_DEC); const float* SS = (const float*)(ws + WS_SS);
    const float* MIXED = (const float*)(ws + WS_PA);
    for (size_t i = (size_t)bx * 512 + tid; i < (size_t)M * DM; i += (size_t)256 * 512) {
        const int m = (int)(i >> 10), c = (int)(i & 1023);
        float o = 0.f;
        if (stage == 1) o = bflo(PA[(size_t)m * 1536 + c]) + bflo(PB[(size_t)m * 1536 + c]) + bflo(PA[(size_t)m * 1536 + 1024 + (c & 511)]) + bflo(PB[(size_t)m * 1536 + 1024 + (c & 511)]) + LR[(size_t)m * 32 + (c & 31)] + 1e-3f * VSTAT[(size_t)m * 16 + (c & 15)];
        if (stage == 2) o = bflo(MIX[(size_t)m * 1024 + (c & 511)]) + bflo(KV[i >> 1]) + DEC[i % ((size_t)NUNIT * 128)];
        if (stage == 3) o = bflo(KV[i >> 1]);
        if (stage == 4) o = bflo(MIX[i]);
        if (stage == 5) o = MIXED[i] + 1e-3f * SS[(size_t)m * 16 + (c & 15)];
        a.out[i] = o;
    }
}
__global__ void __launch_bounds__(NWAVES * 64, 2) fwd_kernel(Args args) {
    extern __shared__ __attribute__((aligned(16))) unsigned char lds_raw[];
    LAS unsigned char* lds = (LAS unsigned char*)lds_raw;
    volatile LAS unsigned* MISC = (volatile LAS unsigned*)(lds + MISC_OFF);
    const int tid = threadIdx.x, lane = tid & 63, wave = __builtin_amdgcn_readfirstlane(tid >> 6);
    const int bx = blockIdx.x, G = gridDim.x;
    const int vcu = (bx % 8) * (G / 8) + bx / 8;
    for (int u = tid; u < 128; u += NWAVES * 64) ((LAS unsigned*)(lds + MISC_OFF))[u] = 0u;
    __syncthreads();
    unsigned char* ws = args.ws;
    XcdBarrier bar = xcd_barrier_post((unsigned*)(ws + WS_CTL) + CW_BAR, MISC + 8);

    p0_prologue(args, lds, vcu, tid, lane, wave);
    xcd_barrier(bar);
    {
        pg8::Gemm g{(const pg8::bf16_t*)(ws + WS_XB), (const pg8::bf16_t*)(ws + WS_W1T), M, N1, DM};
        pg8::StaticOrder S; S.init(M, N1, G, bx);
        pg8::EpiP1 E{(pg8::bf16_t*)(ws + WS_PA), (pg8::bf16_t*)(ws + WS_PB), (float*)(ws + WS_VSTAT)};
        pg8::gemm_phase<pg8::EpiP1, pg8::StaticOrder, true, true>(lds, g, S, E);
    }
    xcd_barrier(bar);
    if (DBG_STAGE == 1) { dbg_dump(args, 1, bx, tid); return; }
    for (int u = vcu; u < NUNIT; u += G) p2a_unit(args, lds, u, tid, lane, wave);
    xcd_barrier(bar);
    if (DBG_STAGE == 2) { dbg_dump(args, 2, bx, tid); return; }
    p2b_scan(args, bx, tid);
    xcd_barrier(bar);
    if (DBG_STAGE == 3) { dbg_dump(args, 3, bx, tid); return; }
    for (int u = vcu; u < NUNIT; u += G) p2c_unit(args, lds, u, tid, lane, wave);
    xcd_barrier(bar);
    if (DBG_STAGE == 4) { dbg_dump(args, 4, bx, tid); return; }
    {
        pg8::Gemm g{(const pg8::bf16_t*)(ws + WS_XB), (const pg8::bf16_t*)(ws + WS_W2T), M, DM, DM};
        pg8::StaticOrder S; S.init(M, DM, G, bx);
        pg8::EpiMixed E{(float*)(ws + WS_PA), (float*)(ws + WS_SS)};
        pg8::gemm_phase<pg8::EpiMixed, pg8::StaticOrder, true, true>(lds, g, S, E);
    }
    xcd_barrier(bar);
    if (DBG_STAGE == 5) { dbg_dump(args, 5, bx, tid); return; }
    p4_final(args, vcu, lane, wave);
}

extern "C" void kernel_launch(void* const* d_in, const int* in_sizes, int n_in, void* d_out, int out_size, void* d_ws, size_t ws_size, hipStream_t stream) {
    static int grid = 0;
    if (grid == 0) {
        if (n_in != 14 || in_sizes[0] != M_PROMPT * DM || in_sizes[1] != M_SAMPLE * DM || out_size != M * DM || ws_size < WS_END) {
            fprintf(stderr, "kernel_launch: unexpected shapes (n_in %d, in0 %d, in1 %d, out %d, ws %zu); nothing launched\n", n_in, n_in > 0 ? in_sizes[0] : -1, n_in > 1 ? in_sizes[1] : -1, out_size, ws_size); grid = -1; return; }
        int dev = 0, cus = 0;
        if (hipGetDevice(&dev) != hipSuccess || hipDeviceGetAttribute(&cus, hipDeviceAttributeMultiprocessorCount, dev) != hipSuccess) { grid = -1; return; }
        if (hipFuncSetAttribute((const void*)fwd_kernel, hipFuncAttributeMaxDynamicSharedMemorySize, LDS_BYTES) != hipSuccess) { fprintf(stderr, "kernel_launch: hipFuncSetAttribute failed\n"); grid = -1; return; }
        (void)hipGetLastError();
        grid = cus;
        if (grid != 256) { fprintf(stderr, "kernel_launch: built for 256 CUs, device has %d; nothing launched\n", cus); grid = -1; return; }
    }
    if (grid < 0) return;
    if (hipMemsetAsync((char*)d_ws + WS_CTL, 0, CTL_ZERO_BYTES, stream) != hipSuccess) return;
    Args a{};
    a.xp = (const float*)d_in[0]; a.xs = (const float*)d_in[1]; a.norm_pre = (const float*)d_in[2]; a.w_in = (const float*)d_in[3]; a.w_sp = (const float*)d_in[4];
    a.b_sp = (const float*)d_in[5]; a.g_v_a = (const float*)d_in[6]; a.w_gk_f = (const float*)d_in[7]; a.b_gk_f = (const float*)d_in[8]; a.w_gk_b = (const float*)d_in[9];
    a.b_gk_b = (const float*)d_in[10]; a.g_norm_b = (const float*)d_in[11]; a.w_out = (const float*)d_in[12]; a.norm_post = (const float*)d_in[13];
    a.out = (float*)d_out; a.ws = (unsigned char*)d_ws;
    hipLaunchKernelGGL(fwd_kernel, dim3(grid), dim3(NWAVES * 64), LDS_BYTES, stream, a);
}
```
